# Optimizing an MI355X kernel written in HIP

```python
import jax, jax.numpy as jnp
from jax import lax
import numpy as np

D_MODEL = 1024
BATCH = 16
SEQ = 2048
DEPTH = 1

GRID_W = 64
CTX_LEN = 256
CHUNK = 64
EPS = 1e-6
N_MOD = 6

SSD_HEAD_DIM = 64
SSD_D_INNER = D_MODEL
SSD_HEADS = SSD_D_INNER // SSD_HEAD_DIM
SSD_GROUPS = 4
SSD_STATE = 128
SSD_CONV_W = 3
SSD_XBC = SSD_D_INNER + 2 * SSD_GROUPS * SSD_STATE

GLA_HEADS = 4
GLA_KEY_DIM = D_MODEL // 2
GLA_VAL_DIM = D_MODEL
GLA_DK = GLA_KEY_DIM // GLA_HEADS
GLA_DV = GLA_VAL_DIM // GLA_HEADS
GLA_GATE_RANK = 16
GLA_GATE_NORM = 16.0

D_FF = 256 * ((8 * D_MODEL // 3 + 255) // 256)
FFN_CONV_W = 3

IN_SIZES = (SSD_D_INNER, SSD_XBC, 2 * SSD_HEADS, GLA_KEY_DIM, GLA_KEY_DIM, GLA_VAL_DIM, GLA_GATE_RANK, GLA_VAL_DIM)
IN_DIM = sum(IN_SIZES)

kernel_name = "hybrid_ssd_gla_convffn_dit"


def rmsnorm(x, g):
    xf = x.astype(jnp.float32)
    y = xf * lax.rsqrt(jnp.mean(xf * xf, axis=-1, keepdims=True) + EPS)
    return y.astype(x.dtype) * g


def modulate(x, shift, scale):
    return x * (1.0 + scale) + shift


def adaln(cond, w, b):
    mod = jax.nn.silu(cond) @ w + b
    return mod.reshape(cond.shape[0], N_MOD, 1, D_MODEL)


def _rev(t):
    return jnp.flip(t, axis=1)


def dwconv1d(x, w, b):
    width = w.shape[0]
    pad = width // 2
    L = x.shape[1]
    xp = jnp.pad(x, ((0, 0), (pad, pad), (0, 0)))
    out = xp[:, 0:L] * w[0]
    for i in range(1, width):
        out = out + xp[:, i:i + L] * w[i]
    return out + b


def chunk_recurrence(decay, states, init):
    def step(h, inp):
        d, s = inp
        return d * h + s, h
    h_final, h_prev = lax.scan(step, init, (jnp.moveaxis(decay, 1, 0), jnp.moveaxis(states, 1, 0)))
    return jnp.moveaxis(h_prev, 0, 1), h_final


def ssd_scan(x, dt, a, bmat, cmat, init, with_output):
    bsz, L, H, P = x.shape
    G, N = bmat.shape[-2:]
    R = H // G
    nc = L // CHUNK
    f32 = jnp.float32
    dt = dt.astype(f32)
    xd = (x.astype(f32) * dt[..., None]).reshape(bsz, nc, CHUNK, G, R, P)
    da = (dt * a.astype(f32)).reshape(bsz, nc, CHUNK, G, R)
    bm = bmat.astype(f32).reshape(bsz, nc, CHUNK, G, N)
    cm = cmat.astype(f32).reshape(bsz, nc, CHUNK, G, N)
    cum = jnp.cumsum(da, axis=2)
    last = cum[:, :, -1]
    states = jnp.einsum("bcsgn,bcsgr,bcsgrp->bcgrpn", bm, jnp.exp(last[:, :, None] - cum), xd)
    if init is None:
        init = jnp.zeros((bsz, G, R, P, N), f32)
    h_prev, h_final = chunk_recurrence(jnp.exp(last)[..., None, None], states, init)
    if not with_output:
        return None, h_final
    tri = jnp.tril(jnp.ones((CHUNK, CHUNK), bool))[:, :, None, None]
    seg = cum[:, :, :, None] - cum[:, :, None, :]
    decay = jnp.exp(jnp.where(tri, seg, -jnp.inf))
    cb = jnp.einsum("bcqgn,bcsgn->bcqsg", cm, bm)
    y = (jnp.einsum("bcqsg,bcqsgr,bcsgrp->bcqgrp", cb, decay, xd)
         + jnp.einsum("bcqgn,bcqgr,bcgrpn->bcqgrp", cm, jnp.exp(cum), h_prev))
    return y.reshape(bsz, L, H, P).astype(x.dtype), h_final


def gla_scan(q, k, v, log_a, init, with_output):
    bsz, L, H, K = q.shape
    V = v.shape[-1]
    nc = L // CHUNK
    f32 = jnp.float32
    qc = q.astype(f32).reshape(bsz, nc, CHUNK, H, K)
    kc = k.astype(f32).reshape(bsz, nc, CHUNK, H, K)
    vc = v.astype(f32).reshape(bsz, nc, CHUNK, H, V)
    cum = jnp.cumsum(log_a.astype(f32).reshape(bsz, nc, CHUNK, H, K), axis=2)
    last = cum[:, :, -1]
    states = jnp.einsum("bcshk,bcshv->bchkv", kc * jnp.exp(last[:, :, None] - cum), vc)
    if init is None:
        init = jnp.zeros((bsz, H, K, V), f32)
    h_prev, h_final = chunk_recurrence(jnp.exp(last)[..., None], states, init)
    if not with_output:
        return None, h_final
    ref = cum[:, :, CHUNK // 2 - 1:CHUNK // 2]
    scores = jnp.einsum("bcqhk,bcshk->bchqs", qc * jnp.exp(cum - ref), kc * jnp.exp(ref - cum))
    tri = jnp.tril(jnp.ones((CHUNK, CHUNK), bool))
    scores = jnp.where(tri, scores, 0.0)
    o = (jnp.einsum("bchqs,bcshv->bcqhv", scores, vc)
         + jnp.einsum("bcqhk,bchkv->bcqhv", qc * jnp.exp(cum), h_prev))
    return o.reshape(bsz, L, H, V).astype(v.dtype), h_final


def token_mixer(h, init, with_output, w_in, conv_w, conv_b, dt_bias, a_log, d_skip, ssd_norm_g,
                gla_gate_w, gla_gate_b, gla_norm_g, w_br_ssd, w_br_gla, w_merge, b_merge, w_o):
    bsz, L, _ = h.shape
    proj = h @ w_in
    z, xbc, dt_raw, q, k, v, g_lr, r = jnp.split(proj, np.cumsum(IN_SIZES)[:-1].tolist(), axis=-1)
    s0 = (None, None, None, None) if init is None else init

    xbc = jax.nn.silu(dwconv1d(xbc, conv_w, conv_b))
    xs, bm, cm = jnp.split(xbc, [SSD_D_INNER, SSD_D_INNER + SSD_GROUPS * SSD_STATE], axis=-1)
    xs = xs.reshape(bsz, L, SSD_HEADS, SSD_HEAD_DIM)
    bm = bm.reshape(bsz, L, SSD_GROUPS, SSD_STATE)
    cm = cm.reshape(bsz, L, SSD_GROUPS, SSD_STATE)
    dt = jax.nn.softplus(dt_raw.reshape(bsz, L, 2, SSD_HEADS) + dt_bias)
    a = -jnp.exp(a_log.astype(jnp.float32))
    y_f, sf = ssd_scan(xs, dt[:, :, 0], a[0], bm, cm, s0[0], with_output)
    y_b, sb = ssd_scan(_rev(xs), _rev(dt[:, :, 1]), a[1], _rev(bm), _rev(cm), s0[1], with_output)

    q = q.reshape(bsz, L, GLA_HEADS, GLA_DK) * (GLA_DK ** -0.5)
    k = k.reshape(bsz, L, GLA_HEADS, GLA_DK)
    v = v.reshape(bsz, L, GLA_HEADS, GLA_DV)
    log_a = jax.nn.log_sigmoid(jnp.einsum("blr,drk->bldk", g_lr, gla_gate_w) + gla_gate_b) / GLA_GATE_NORM
    log_a = log_a.reshape(bsz, L, 2, GLA_HEADS, GLA_DK)
    o_f, gf = gla_scan(q, k, v, log_a[:, :, 0], s0[2], with_output)
    o_b, gb = gla_scan(_rev(q), _rev(k), _rev(v), _rev(log_a[:, :, 1]), s0[3], with_output)
    states = (sf, sb, gf, gb)
    if not with_output:
        return None, states

    y = y_f + _rev(y_b) + d_skip[:, None] * xs
    y = rmsnorm(y.reshape(bsz, L, SSD_D_INNER) * jax.nn.silu(z), ssd_norm_g)
    o = rmsnorm(o_f + _rev(o_b), gla_norm_g).reshape(bsz, L, GLA_VAL_DIM) * jax.nn.silu(r)

    gates = jax.nn.sigmoid(h @ w_merge + b_merge)
    g_ssd, g_gla = jnp.split(gates, 2, axis=-1)
    out = (g_ssd * (y @ w_br_ssd) + g_gla * (o @ w_br_gla)) @ w_o
    return out, states


def conv_ffn(h, w_up, conv_w, conv_b, w_down, rows):
    u = h @ w_up
    if rows is None:
        u = dwconv1d(u, conv_w[FFN_CONV_W // 2], conv_b)
    else:
        bsz, L, ch = u.shape
        grid = u.reshape(bsz, rows, GRID_W, ch)
        grid = lax.conv_general_dilated(grid, conv_w[:, :, None, :], (1, 1), "SAME",
                                        dimension_numbers=("NHWC", "HWIO", "NHWC"),
                                        feature_group_count=ch)
        u = grid.reshape(bsz, L, ch) + conv_b
    gate, val = jnp.split(u, 2, axis=-1)
    return (jax.nn.silu(gate) * val) @ w_down


def setup_inputs(seed: int = 0) -> dict:
    key = jax.random.key(seed)
    ks = jax.random.split(key, 32)
    f32 = jnp.float32
    nrm = lambda k, shape, s: jax.random.normal(k, shape, f32) * s
    gain = lambda k, shape: 1.0 + 0.1 * jax.random.normal(k, shape, f32)
    dt0 = jnp.exp(jax.random.uniform(ks[8], (DEPTH, 2, SSD_HEADS), f32) * (np.log(0.1) - np.log(0.001)) + np.log(0.001))
    return {
        "x": nrm(ks[0], (BATCH, SEQ, D_MODEL), 1.0),
        "c": nrm(ks[1], (BATCH, D_MODEL), 1.0),
        "ctx": nrm(ks[2], (BATCH, CTX_LEN, D_MODEL), 1.0),
        "c_ctx": nrm(ks[3], (D_MODEL,), 1.0),
        "w_ada": nrm(ks[4], (DEPTH, D_MODEL, N_MOD * D_MODEL), 0.5 * D_MODEL ** -0.5),
        "b_ada": nrm(ks[5], (DEPTH, N_MOD * D_MODEL), 0.02),
        "norm1_g": gain(ks[6], (DEPTH, D_MODEL)),
        "w_in": nrm(ks[7], (DEPTH, D_MODEL, IN_DIM), D_MODEL ** -0.5),
        "ssd_conv_w": nrm(ks[9], (DEPTH, SSD_CONV_W, SSD_XBC), SSD_CONV_W ** -0.5),
        "ssd_conv_b": nrm(ks[10], (DEPTH, SSD_XBC), 0.02),
        "ssd_dt_bias": dt0 + jnp.log(-jnp.expm1(-dt0)),
        "ssd_a_log": jnp.log(jax.random.uniform(ks[11], (DEPTH, 2, SSD_HEADS), f32, 1.0, 16.0)),
        "ssd_d": gain(ks[12], (DEPTH, SSD_HEADS)),
        "ssd_norm_g": gain(ks[13], (DEPTH, SSD_D_INNER)),
        "gla_gate_w": nrm(ks[14], (DEPTH, 2, GLA_GATE_RANK, GLA_KEY_DIM), GLA_GATE_RANK ** -0.5),
        "gla_gate_b": nrm(ks[15], (DEPTH, 2, GLA_KEY_DIM), 0.1),
        "gla_norm_g": gain(ks[16], (DEPTH, GLA_DV)),
        "w_br_ssd": nrm(ks[17], (DEPTH, SSD_D_INNER, D_MODEL), SSD_D_INNER ** -0.5),
        "w_br_gla": nrm(ks[18], (DEPTH, GLA_VAL_DIM, D_MODEL), GLA_VAL_DIM ** -0.5),
        "w_merge": nrm(ks[19], (DEPTH, D_MODEL, 2 * D_MODEL), D_MODEL ** -0.5),
        "b_merge": nrm(ks[20], (DEPTH, 2 * D_MODEL), 0.02),
        "w_o": nrm(ks[21], (DEPTH, D_MODEL, D_MODEL), D_MODEL ** -0.5),
        "norm2_g": gain(ks[22], (DEPTH, D_MODEL)),
        "w_up": nrm(ks[23], (DEPTH, D_MODEL, 2 * D_FF), D_MODEL ** -0.5),
        "ffn_conv_w": nrm(ks[24], (DEPTH, FFN_CONV_W, FFN_CONV_W, 2 * D_FF), 1.0 / FFN_CONV_W),
        "ffn_conv_b": nrm(ks[25], (DEPTH, 2 * D_FF), 0.02),
        "w_down": nrm(ks[26], (DEPTH, D_FF, D_MODEL), D_FF ** -0.5),
        "final_norm_g": gain(ks[27], (D_MODEL,)),
    }


def reference(x, c, ctx, c_ctx, w_ada, b_ada, norm1_g, w_in, ssd_conv_w, ssd_conv_b, ssd_dt_bias,
              ssd_a_log, ssd_d, ssd_norm_g, gla_gate_w, gla_gate_b, gla_norm_g, w_br_ssd, w_br_gla,
              w_merge, b_merge, w_o, norm2_g, w_up, ffn_conv_w, ffn_conv_b, w_down, final_norm_g):
    rows = x.shape[1] // GRID_W
    for l in range(DEPTH):
        last = l == DEPTH - 1
        lp = dict(w_in=w_in[l], conv_w=ssd_conv_w[l], conv_b=ssd_conv_b[l], dt_bias=ssd_dt_bias[l],
                  a_log=ssd_a_log[l], d_skip=ssd_d[l], ssd_norm_g=ssd_norm_g[l],
                  gla_gate_w=gla_gate_w[l], gla_gate_b=gla_gate_b[l], gla_norm_g=gla_norm_g[l],
                  w_br_ssd=w_br_ssd[l], w_br_gla=w_br_gla[l], w_merge=w_merge[l], b_merge=b_merge[l],
                  w_o=w_o[l])
        mx = adaln(c, w_ada[l], b_ada[l])
        mc = adaln(c_ctx[None], w_ada[l], b_ada[l])

        h_ctx = modulate(rmsnorm(ctx, norm1_g[l]), mc[:, 0], mc[:, 1])
        out_ctx, ctx_states = token_mixer(h_ctx, None, not last, **lp)

        h_x = modulate(rmsnorm(x, norm1_g[l]), mx[:, 0], mx[:, 1])
        out_x, _ = token_mixer(h_x, ctx_states, True, **lp)
        x = x + mx[:, 2] * out_x
        h2 = modulate(rmsnorm(x, norm2_g[l]), mx[:, 3], mx[:, 4])
        x = x + mx[:, 5] * conv_ffn(h2, w_up[l], ffn_conv_w[l], ffn_conv_b[l], w_down[l], rows)

        if not last:
            ctx = ctx + mc[:, 2] * out_ctx
            h2c = modulate(rmsnorm(ctx, norm2_g[l]), mc[:, 3], mc[:, 4])
            ctx = ctx + mc[:, 5] * conv_ffn(h2c, w_up[l], ffn_conv_w[l], ffn_conv_b[l], w_down[l], None)
    return rmsnorm(x, final_norm_g)
```

```cpp
#include <hip/hip_runtime.h>
#include <cstdio>
#include <cstdint>

#ifndef MK_N_LAUNCHES
#define MK_N_LAUNCHES 16
#endif

#define LAS __attribute__((address_space(3)))
#define GAS __attribute__((address_space(1)))
typedef unsigned short bf16_t;
typedef unsigned char uchar;
typedef short bf16x8 __attribute__((ext_vector_type(8)));
typedef short s16x4 __attribute__((ext_vector_type(4)));
typedef float f32x2 __attribute__((ext_vector_type(2)));
typedef float f32x4 __attribute__((ext_vector_type(4)));
typedef float f32x16 __attribute__((ext_vector_type(16)));
typedef unsigned u32x2 __attribute__((ext_vector_type(2)));
typedef unsigned u32x4 __attribute__((ext_vector_type(4)));

constexpr int D = 1024, NB = 16, SEQ = 2048, CTX = 256;
constexpr int MX = NB * SEQ;
constexpr int MC = NB * CTX;
constexpr int MALL = MX + MC;
constexpr int NMOD = 6 * D;
constexpr int DFF = 2816;
constexpr int NG1 = 8448;
constexpr float EPS = 1e-6f;
constexpr int NPH = 16;

constexpr size_t MiB = (size_t)1 << 20;
constexpr size_t WS_CTL = 0, CTL_ZERO_BYTES = 1 * MiB;
constexpr size_t WS_MODS = 1 * MiB;
constexpr size_t WS_WG1T = 2 * MiB, WS_WBS = 19 * MiB, WS_WBG = 21 * MiB, WS_WO = 23 * MiB, WS_WUP = 25 * MiB, WS_WDN = 36 * MiB;
constexpr size_t WS_XBC = 48 * MiB, WS_V = 192 * MiB, WS_K = 264 * MiB, WS_Q = 300 * MiB, WS_DT = 336 * MiB, WS_GLR = 341 * MiB, WS_YY = 384 * MiB;
constexpr size_t WS_HX = 48 * MiB, WS_Z = 112 * MiB, WS_R = 176 * MiB, WS_GATES = 240 * MiB;
constexpr size_t WS_P = 48 * MiB, WS_MERGED = 112 * MiB;
constexpr size_t WS_H2 = 48 * MiB, WS_UA = 176 * MiB, WS_ACT = 336 * MiB, WS_UB = 112 * MiB;
constexpr size_t WS_END = 512 * MiB;
constexpr int CW_BAR = 4096;

constexpr int LDS_BYTES = 163840;
constexpr int MISC_OFF = LDS_BYTES - 256;

__device__ __forceinline__ unsigned cvt_pk_bf16(float lo, float hi) {
    typedef __bf16 b2 __attribute__((ext_vector_type(2)));
    f32x2 v = {lo, hi}; b2 b = __builtin_convertvector(v, b2); return __builtin_bit_cast(unsigned, b);
}
__device__ __forceinline__ float bf_lo(unsigned u) { return __uint_as_float(u << 16); }
__device__ __forceinline__ float bf_hi(unsigned u) { return __uint_as_float(u & 0xffff0000u); }
__device__ __forceinline__ float fast_rcp(float x) { return __builtin_amdgcn_rcpf(x); }
__device__ __forceinline__ float silu_f(float x) { return x * fast_rcp(1.0f + __expf(-x)); }
__device__ __forceinline__ float sigmoid_f(float x) { return fast_rcp(1.0f + __expf(-x)); }
__device__ __forceinline__ float wave_sum(float v) {
#pragma unroll
    for (int o = 1; o < 64; o <<= 1) v += __shfl_xor(v, o);
    return v;
}

namespace pg8 {
constexpr int BM = 256, BK = 64, HALF = 128, HTB = HALF * BK * 2, STAGE_BYTES = 8 * HTB, NXCD = 8, WGM = 8;
__host__ __device__ __forceinline__ int lds_byte(int r, int c) { const int st = (r >> 4) * 2 + (c >> 5), rr = r & 15, cc = c & 31, ob = rr * 64 + cc * 2; return st * 1024 + (ob ^ (((ob >> 9) & 1) << 5)); }
__host__ __device__ __forceinline__ void stage_rc(int b, int& R, int& C) { const int st = b / 1024, sb = b % 1024, swz = sb ^ (((sb >> 9) & 1) << 5); R = (st >> 1) * 16 + swz / 64; C = (st & 1) * 32 + (swz % 64) / 2; }
__host__ __device__ __forceinline__ int perm32(int rho) { const int n = rho >> 4, i = rho & 15; return 8 * (i >> 2) + 4 * n + (i & 3); }

struct Unit { int pm, pn; };
struct Gemm { const bf16_t* A; const bf16_t* Bt; int lda, K; };

struct Sched {
    int nM, nN, nwg, G, c, eM0, eM, eN;
    __device__ void init(int nM_, int nN_, int G_, int c_, int eM0_ = 0, int eM_ = 0, int eN_ = 0) { nM = nM_; nN = nN_; nwg = nM * nN; G = G_; c = c_; eM0 = eM0_; eM = eM_; eN = eN_; }
    __device__ bool next(int i, Unit& u) const {
        const long L = (long)i * G + c;
        if (L >= nwg) { const long e = L - nwg; if (e >= (long)eM * eN) return false; u.pm = eM0 + (int)(e % eM); u.pn = (int)(e / eM); return true; }
        int wgid = (int)L; { const int q = nwg / NXCD, r = nwg % NXCD, xcd = wgid % NXCD, off = wgid / NXCD; wgid = (xcd < r ? xcd * (q + 1) : r * (q + 1) + (xcd - r) * q) + off; }
        const int nig = WGM * nN, gid = wgid / nig, fm = gid * WGM, gsz = (nM - fm) < WGM ? (nM - fm) : WGM;
        u.pm = fm + ((wgid % nig) % gsz); u.pn = (wgid % nig) / gsz; return true;
    }
};

template <class Epi, bool ALIGN_EPI = true>
__device__ __forceinline__ void gemm_phase(LAS uchar* lds, const Gemm g, const Sched& S, const Epi& E) {
    const int tid = threadIdx.x, wid = __builtin_amdgcn_readfirstlane(tid >> 6), lane = tid & 63, wr = wid >> 2, wc = wid & 3, fr = lane & 15, fq = lane >> 4;
    const int K = g.K, nt = K / BK, lda = g.lda;
    unsigned voffA[2], voffB[2];
#pragma unroll
    for (int i = 0; i < 2; ++i) { int R, C; stage_rc(tid * 16 + i * 8192, R, C); const int Rb = Epi::PERM ? ((R & ~31) + perm32(R & 31)) : R;
        voffA[i] = (unsigned)(R * lda + C) * 2u; voffB[i] = (unsigned)(Rb * K + C) * 2u; }
    const size_t kstep = (size_t)(BK * 2);
    const size_t hstepA = (size_t)HALF * lda * 2, hstepB = (size_t)HALF * K * 2;
    const size_t tstepA = 2 * hstepA, tstepB = 2 * hstepB;
    const unsigned ldsw = (unsigned)wid * 1024u;
    const int aoff = lds_byte(wr * 64 + fr, fq * 8), boff = lds_byte(wc * 32 + fr, fq * 8);
#define PG8_SA(b, h) (((b) * 2 + (h)) * HTB)
#define PG8_SB(b, h) ((4 + (b) * 2 + (h)) * HTB)
#define PG8_STAGE(bufoff, gbase, voff) do { _Pragma("unroll") for (int _i = 0; _i < 2; ++_i) \
        __builtin_amdgcn_global_load_lds((const unsigned*)((const char*)(gbase) + (voff)[_i]), (LAS unsigned*)(lds + (bufoff) + ldsw + _i * 8192), 16, 0, 0); } while (0)
#define PG8_LDA(dst, b, h) do { _Pragma("unroll") for (int m = 0; m < 4; ++m) _Pragma("unroll") for (int k = 0; k < 2; ++k) dst[m][k] = *(const LAS bf16x8*)(lds + PG8_SA(b, h) + aoff + m * 2048 + k * 1024); } while (0)
#define PG8_LDB(dst, b, h) do { _Pragma("unroll") for (int n = 0; n < 2; ++n) _Pragma("unroll") for (int k = 0; k < 2; ++k) dst[n][k] = *(const LAS bf16x8*)(lds + PG8_SB(b, h) + boff + n * 2048 + k * 1024); } while (0)
#define PG8_MMA(ai, bj, At, Bt) do { __builtin_amdgcn_s_setprio(1); _Pragma("unroll") for (int m = 0; m < 4; ++m) _Pragma("unroll") for (int n = 0; n < 2; ++n) _Pragma("unroll") for (int k = 0; k < 2; ++k) \
        acc[ai][bj][m][n] = __builtin_amdgcn_mfma_f32_16x16x32_bf16(Bt[n][k], At[m][k], acc[ai][bj][m][n], 0, 0, 0); __builtin_amdgcn_s_setprio(0); } while (0)
#define PG8_WAIT_V(n) asm volatile("s_waitcnt vmcnt(" #n ")" ::: "memory")
#define PG8_WAIT_L(n) asm volatile("s_waitcnt lgkmcnt(" #n ")" ::: "memory")
#define PG8_BAR __builtin_amdgcn_s_barrier()
#define PG8_SCHED __builtin_amdgcn_sched_barrier(0)
    Unit cur, nxt; int ui = 0;
    if (!S.next(0, cur)) return;
    f32x4 acc[2][2][4][2];
#pragma unroll
    for (int a = 0; a < 2; ++a)
#pragma unroll
        for (int b = 0; b < 2; ++b)
#pragma unroll
            for (int m = 0; m < 4; ++m)
#pragma unroll
                for (int n = 0; n < 2; ++n) acc[a][b][m][n] = (f32x4){0.f, 0.f, 0.f, 0.f};
    bf16x8 At[4][2], B0[2][2], B1[2][2];
    const char* cA = (const char*)g.A + (size_t)cur.pm * tstepA; const char* cB = (const char*)g.Bt + (size_t)cur.pn * tstepB;
    PG8_STAGE(PG8_SB(0, 0), cB, voffB); PG8_STAGE(PG8_SB(0, 1), cB + hstepB, voffB); PG8_STAGE(PG8_SA(0, 0), cA, voffA); PG8_STAGE(PG8_SA(0, 1), cA + hstepA, voffA);
    if (wr == 1) PG8_BAR;
    PG8_WAIT_V(2); PG8_BAR;
    PG8_STAGE(PG8_SB(1, 0), cB + kstep, voffB); PG8_STAGE(PG8_SA(1, 0), cA + kstep, voffA); PG8_STAGE(PG8_SB(1, 1), cB + hstepB + kstep, voffB);
    PG8_WAIT_V(6); PG8_BAR;
    for (;;) {
        const bool has_next = S.next(ui + 1, nxt);
        const char* nA = has_next ? (const char*)g.A + (size_t)nxt.pm * tstepA : cA; const char* nB = has_next ? (const char*)g.Bt + (size_t)nxt.pn * tstepB : cB;
        for (int t = 0; t < nt; t += 2) {
            const bool last = (t == nt - 2);
            const char* a1 = cA + (size_t)(t + 1) * kstep;
            const char* a2 = last ? nA : cA + (size_t)(t + 2) * kstep; const char* b2 = last ? nB : cB + (size_t)(t + 2) * kstep;
            const char* a3 = a2 + kstep; const char* b3 = b2 + kstep;
            PG8_LDB(B0, 0, 0); PG8_LDB(B1, 0, 1); PG8_SCHED; PG8_LDA(At, 0, 0); PG8_STAGE(PG8_SA(1, 1), a1 + hstepA, voffA);
            PG8_WAIT_V(8); PG8_WAIT_L(0); PG8_BAR; PG8_MMA(0, 0, At, B0); PG8_MMA(0, 1, At, B1); PG8_BAR; PG8_SCHED;
            PG8_LDA(At, 0, 1); PG8_STAGE(PG8_SB(0, 0), b2, voffB); PG8_STAGE(PG8_SB(0, 1), b2 + hstepB, voffB); PG8_STAGE(PG8_SA(0, 0), a2, voffA);
            PG8_WAIT_V(8); PG8_WAIT_L(0); PG8_BAR; PG8_MMA(1, 0, At, B0); PG8_MMA(1, 1, At, B1); PG8_BAR; PG8_SCHED;
            PG8_LDB(B0, 1, 0); PG8_LDB(B1, 1, 1); PG8_SCHED; PG8_LDA(At, 1, 0); PG8_STAGE(PG8_SA(0, 1), a2 + hstepA, voffA);
            PG8_WAIT_V(8); PG8_WAIT_L(0); PG8_BAR; PG8_MMA(0, 0, At, B0); PG8_MMA(0, 1, At, B1); PG8_BAR; PG8_SCHED;
            PG8_LDA(At, 1, 1); PG8_STAGE(PG8_SB(1, 0), b3, voffB); PG8_STAGE(PG8_SB(1, 1), b3 + hstepB, voffB); PG8_STAGE(PG8_SA(1, 0), a3, voffA);
            PG8_WAIT_V(8); PG8_WAIT_L(0); PG8_BAR; PG8_MMA(1, 0, At, B0); PG8_MMA(1, 1, At, B1); PG8_BAR; PG8_SCHED;
        }
        if constexpr (ALIGN_EPI) { if (wr == 0) PG8_BAR; }
        E(acc, cur, wr, wc, fr, fq);
        if (!has_next) break;
#pragma unroll
        for (int a = 0; a < 2; ++a)
#pragma unroll
            for (int b = 0; b < 2; ++b)
#pragma unroll
                for (int m = 0; m < 4; ++m)
#pragma unroll
                    for (int n = 0; n < 2; ++n) acc[a][b][m][n] = (f32x4){0.f, 0.f, 0.f, 0.f};
        cur = nxt; cA = nA; cB = nB; ++ui;
        if constexpr (ALIGN_EPI) { if (wr == 1) PG8_BAR; }
    }
    PG8_WAIT_V(0);
    if constexpr (!ALIGN_EPI) { if (wr == 0) PG8_BAR; }
    PG8_BAR;
#undef PG8_SA
#undef PG8_SB
#undef PG8_STAGE
#undef PG8_LDA
#undef PG8_LDB
#undef PG8_MMA
#undef PG8_WAIT_V
#undef PG8_WAIT_L
#undef PG8_BAR
#undef PG8_SCHED
}
}

enum { EK_G1 = 0, EK_G2A = 1, EK_G2B = 2, EK_PLAIN = 3 };
struct EpiBf {
    static constexpr bool PERM = true;
    int kind;
    uchar* ws; const float* dt_bias; const float* b_merge;
    bf16_t* pdst; int pld;
    int pn_off;
    __device__ __forceinline__ void operator()(const f32x4 (&acc)[2][2][4][2], const pg8::Unit& u, int wr, int wc, int fr, int fq) const {
        const int row0 = u.pm * 256 + wr * 64 + fr;
        const int cl = wc * 32 + 8 * fq;
        bf16_t* dst; int ld, dcol; int act = 0;
        const bf16_t* gates = (const bf16_t*)(ws + WS_GATES);
        int gcol = 0;
        if (kind == EK_G1) {
            const int pn = u.pn + pn_off;
            if (pn < 8) { dst = (bf16_t*)(ws + WS_XBC); ld = 2048; dcol = pn * 256; }
            else if (pn < 10) { dst = (bf16_t*)(ws + WS_K); ld = 512; dcol = (pn - 8) * 256; }
            else if (pn < 14) { dst = (bf16_t*)(ws + WS_V); ld = 1024; dcol = (pn - 10) * 256; }
            else if (pn == 14) { dst = nullptr; ld = 0; dcol = 0; act = 6; }
            else if (pn < 17) { dst = (bf16_t*)(ws + WS_Q); ld = 512; dcol = (pn - 15) * 256; act = 1; }
            else if (pn < 21) { dst = (bf16_t*)(ws + WS_Z); ld = 1024; dcol = (pn - 17) * 256; act = 2; }
            else if (pn < 25) { dst = (bf16_t*)(ws + WS_R); ld = 1024; dcol = (pn - 21) * 256; act = 2; }
            else { dst = (bf16_t*)(ws + WS_GATES); ld = 2048; dcol = (pn - 25) * 256; act = 3; }
        } else if (kind == EK_G2A) { dst = (bf16_t*)(ws + WS_P); ld = 1024; dcol = u.pn * 256; act = 4; gcol = u.pn * 256; }
        else if (kind == EK_G2B) { dst = (bf16_t*)(ws + WS_MERGED); ld = 1024; dcol = u.pn * 256; act = 5; gcol = 1024 + u.pn * 256; }
        else { dst = pdst; ld = pld; dcol = u.pn * 256; }
        if (act == 6) {
            float* DT = (float*)(ws + WS_DT); bf16_t* GLR = (bf16_t*)(ws + WS_GLR);
            if (wc == 0) {
                const f32x4 b0 = *(const f32x4*)(dt_bias + cl), b1 = *(const f32x4*)(dt_bias + cl + 4);
#pragma unroll
                for (int ai = 0; ai < 2; ++ai)
#pragma unroll
                    for (int m = 0; m < 4; ++m) {
                        const int row = row0 + ai * 128 + m * 16;
                        f32x4 v0 = acc[ai][0][m][0] + b0, v1 = acc[ai][0][m][1] + b1;
#pragma unroll
                        for (int e = 0; e < 4; ++e) { v0[e] = fmaxf(v0[e], 0.f) + log1pf(__expf(-fabsf(v0[e]))); v1[e] = fmaxf(v1[e], 0.f) + log1pf(__expf(-fabsf(v1[e]))); }
                        *(f32x4*)(DT + (size_t)row * 32 + cl) = v0; *(f32x4*)(DT + (size_t)row * 32 + cl + 4) = v1;
                    }
            } else if (wc == 1 && fq < 2) {
#pragma unroll
                for (int ai = 0; ai < 2; ++ai)
#pragma unroll
                    for (int m = 0; m < 4; ++m) {
                        const int row = row0 + ai * 128 + m * 16;
                        const f32x4 v0 = acc[ai][0][m][0], v1 = acc[ai][0][m][1];
                        u32x4 w; w.x = cvt_pk_bf16(v0[0], v0[1]); w.y = cvt_pk_bf16(v0[2], v0[3]); w.z = cvt_pk_bf16(v1[0], v1[1]); w.w = cvt_pk_bf16(v1[2], v1[3]);
                        *(u32x4*)(GLR + (size_t)row * 16 + 8 * fq) = w;
                    }
            }
            return;
        }
        f32x4 bv[2][2];
#pragma unroll
        for (int bj = 0; bj < 2; ++bj)
#pragma unroll
            for (int n = 0; n < 2; ++n) bv[bj][n] = (act == 3) ? *(const f32x4*)(b_merge + dcol + cl + bj * 128 + 4 * n) : (f32x4){0.f, 0.f, 0.f, 0.f};
#pragma unroll
        for (int ai = 0; ai < 2; ++ai)
#pragma unroll
            for (int m = 0; m < 4; ++m) {
                const int row = row0 + ai * 128 + m * 16;
                bf16_t* rowp = dst + (size_t)row * ld + dcol + cl;
#pragma unroll
                for (int bj = 0; bj < 2; ++bj) {
                    f32x4 v0 = acc[ai][bj][m][0], v1 = acc[ai][bj][m][1];
                    if (act == 1) { v0 = v0 * 0.08838834764831845f; v1 = v1 * 0.08838834764831845f; }
                    else if (act == 2) {
#pragma unroll
                        for (int e = 0; e < 4; ++e) { v0[e] = silu_f(v0[e]); v1[e] = silu_f(v1[e]); }
                    } else if (act == 3) {
                        v0 = v0 + bv[bj][0]; v1 = v1 + bv[bj][1];
#pragma unroll
                        for (int e = 0; e < 4; ++e) { v0[e] = sigmoid_f(v0[e]); v1[e] = sigmoid_f(v1[e]); }
                    } else if (act == 4 || act == 5) {
                        const u32x4 gg = *(const u32x4*)(gates + (size_t)row * 2048 + gcol + cl + bj * 128);
                        const f32x4 g0 = {bf_lo(gg.x), bf_hi(gg.x), bf_lo(gg.y), bf_hi(gg.y)}, g1 = {bf_lo(gg.z), bf_hi(gg.z), bf_lo(gg.w), bf_hi(gg.w)};
                        v0 = v0 * g0; v1 = v1 * g1;
                        if (act == 5) {
                            const u32x4 pp = *(const u32x4*)((const bf16_t*)(ws + WS_P) + (size_t)row * 1024 + dcol + cl + bj * 128);
                            const f32x4 p0 = {bf_lo(pp.x), bf_hi(pp.x), bf_lo(pp.y), bf_hi(pp.y)}, p1 = {bf_lo(pp.z), bf_hi(pp.z), bf_lo(pp.w), bf_hi(pp.w)};
                            v0 = v0 + p0; v1 = v1 + p1;
                        }
                    }
                    u32x4 w; w.x = cvt_pk_bf16(v0[0], v0[1]); w.y = cvt_pk_bf16(v0[2], v0[3]); w.z = cvt_pk_bf16(v1[0], v1[1]); w.w = cvt_pk_bf16(v1[2], v1[3]);
                    *(u32x4*)(rowp + bj * 128) = w;
                }
            }
    }
};
struct EpiRes {
    static constexpr bool PERM = false;
    const float* base; float* out; const float* gate;
    __device__ __forceinline__ void operator()(const f32x4 (&acc)[2][2][4][2], const pg8::Unit& u, int wr, int wc, int fr, int fq) const {
        const int col0 = u.pn * 256 + wc * 32 + 4 * fq;
        const int b = (u.pm * 256) >> 11;
        f32x4 gv[2][2];
#pragma unroll
        for (int bj = 0; bj < 2; ++bj)
#pragma unroll
            for (int n = 0; n < 2; ++n) gv[bj][n] = *(const f32x4*)(gate + (size_t)b * NMOD + col0 + bj * 128 + n * 16);
#pragma unroll
        for (int ai = 0; ai < 2; ++ai)
#pragma unroll
            for (int m = 0; m < 4; ++m) {
                const size_t off = (size_t)(u.pm * 256 + ai * 128 + wr * 64 + m * 16 + fr) * D + col0;
#pragma unroll
                for (int bj = 0; bj < 2; ++bj)
#pragma unroll
                    for (int n = 0; n < 2; ++n) {
                        const f32x4 bs = *(const f32x4*)(base + off + bj * 128 + n * 16);
                        *(f32x4*)(out + off + bj * 128 + n * 16) = bs + gv[bj][n] * acc[ai][bj][m][n];
                    }
            }
    }
};

#define XB_TMO      128
#define XB_XCNT(j)  (256  + 64 * (j))
#define XB_XSUB(j)  (1280 + 64 * (j))
#define XB_XGEN(j)  (2304 + 64 * (j))
#define XB_TOP      3328
#define XB_TOPGEN   3392
#define XCD_BAR_WORDS 3456
#define XB_SPIN_CAP (1u << 22)
__device__ __forceinline__ unsigned xb_ld(unsigned* p)              { return __hip_atomic_load(p, __ATOMIC_RELAXED, __HIP_MEMORY_SCOPE_AGENT); }
__device__ __forceinline__ unsigned xb_add(unsigned* p, unsigned v) { return __hip_atomic_fetch_add(p, v, __ATOMIC_RELAXED, __HIP_MEMORY_SCOPE_AGENT); }
__device__ __forceinline__ unsigned xb_xcc_id() { return (unsigned)__builtin_amdgcn_s_getreg((3 << 11) | 20) & 0xFu; }
#define XB_SPIN(cond, bar) do { unsigned _sp = 0; while (cond) { __builtin_amdgcn_s_sleep(1); \
    if ((++_sp & 255u) == 0u) { if (xb_ld(&(bar)[XB_TMO])) break; if (_sp > XB_SPIN_CAP) { atomicAdd(&(bar)[XB_TMO], 1u); break; } } } } while (0)
struct XcdBarrier { unsigned* bar; unsigned x; volatile LAS unsigned* st; };
__device__ __forceinline__ XcdBarrier xcd_barrier_post(unsigned* bar, volatile LAS unsigned* st) {
    XcdBarrier b; b.bar = bar; b.x = xb_xcc_id(); b.st = st;
    if (threadIdx.x == 0) (void)xb_add(&bar[XB_XCNT(b.x)], 1u);
    return b;
}
__device__ __forceinline__ void xcd_barrier_complete(unsigned* bar, unsigned x, unsigned& nloc, unsigned& nx) {
    const unsigned G = gridDim.x * gridDim.y * gridDim.z;
    unsigned sum, cnt, mine, sp = 0u;
    for (;;) {
        sum = 0u; cnt = 0u; mine = 0u;
#pragma unroll
        for (unsigned j = 0; j < 16; ++j) { const unsigned c = xb_ld(&bar[XB_XCNT(j)]); sum += c; cnt += (c > 0u) ? 1u : 0u; mine = (j == x) ? c : mine; }
        if (sum == G) break;
        __builtin_amdgcn_s_sleep(1);
        if ((++sp & 255u) == 0u) { if (xb_ld(&bar[XB_TMO])) break; if (sp > XB_SPIN_CAP) { atomicAdd(&bar[XB_TMO], 1u); break; } }
    }
    nloc = mine > 0u ? mine : 1u; nx = cnt > 0u ? cnt : 1u;
}
__device__ __forceinline__ void xcd_barrier(const XcdBarrier& b) {
    asm volatile("s_waitcnt vmcnt(0)" ::: "memory");
    __syncthreads();
    if (threadIdx.x == 0) {
        unsigned* bar = b.bar;
        __builtin_amdgcn_s_waitcnt(0);
        unsigned nloc = b.st[0], nx = b.st[1];
        if (nloc == 0u) { xcd_barrier_complete(bar, b.x, nloc, nx); b.st[0] = nloc; b.st[1] = nx; }
        const unsigned old = xb_add(&bar[XB_XSUB(b.x)], 1u);
        const unsigned gen = old / nloc;
        if (old + 1u == (gen + 1u) * nloc) {
            __builtin_amdgcn_fence(__ATOMIC_RELEASE, "agent");
            asm volatile("s_waitcnt vmcnt(0)" ::: "memory");
            const unsigned og = xb_add(&bar[XB_TOP], 1u);
            const unsigned tg = og / nx;
            if (og + 1u == (tg + 1u) * nx) xb_add(&bar[XB_TOPGEN], 1u);
            else XB_SPIN(xb_ld(&bar[XB_TOPGEN]) == tg, bar);
            __builtin_amdgcn_fence(__ATOMIC_ACQUIRE, "agent");
            xb_add(&bar[XB_XGEN(b.x)], 1u);
            asm volatile("s_waitcnt vmcnt(0)" ::: "memory");
        } else {
            XB_SPIN(xb_ld(&bar[XB_XGEN(b.x)]) == gen, bar);
            __builtin_amdgcn_fence(__ATOMIC_ACQUIRE, "agent");
            asm volatile("s_waitcnt vmcnt(0)" ::: "memory");
        }
    }
    __syncthreads();
}

struct Params { const float* in[28]; float* out; uchar* ws; int ph_lo, ph_hi; };
enum { I_X = 0, I_C, I_CTX, I_CCTX, I_WADA, I_BADA, I_N1G, I_WIN, I_SCW, I_SCB, I_DTB, I_ALOG, I_SSDD, I_SSDNG, I_GGW, I_GGB, I_GLANG, I_WBS, I_WBG, I_WMERGE, I_BMERGE, I_WO, I_N2G, I_WUP, I_FCW, I_FCB, I_WDN, I_FNG };

struct Frame {
    LAS uchar* lds; int tid, lane, wave, G;
    const Params* p;
};

__device__ __forceinline__ void p0_mods(const Params& P, LAS uchar* lds, int tid, int lane, int wave) {
    LAS float* sc = (LAS float*)lds;
    LAS float* red = sc + 17 * 1024;
    const float* c = P.in[I_C]; const float* cctx = P.in[I_CCTX]; const float* wada = P.in[I_WADA]; const float* bada = P.in[I_BADA];
    float* mods = (float*)(P.ws + WS_MODS);
    for (int it = blockIdx.x; it < 96; it += gridDim.x) {
        __syncthreads();
        for (int idx = tid; idx < 17 * 1024; idx += 512) { const int m = idx >> 10, k = idx & 1023; const float v = m < 16 ? c[m * 1024 + k] : cctx[k]; sc[idx] = v / (1.0f + __expf(-v)); }
        __syncthreads();
        const int n = it * 64 + lane;
        float acc[17];
#pragma unroll
        for (int m = 0; m < 17; ++m) acc[m] = 0.f;
        for (int k = wave * 128; k < wave * 128 + 128; k += 4) {
            const float w0 = wada[(size_t)k * NMOD + n], w1 = wada[(size_t)(k + 1) * NMOD + n], w2 = wada[(size_t)(k + 2) * NMOD + n], w3 = wada[(size_t)(k + 3) * NMOD + n];
#pragma unroll
            for (int m = 0; m < 17; ++m) { const f32x4 s4 = *(const LAS f32x4*)(sc + m * 1024 + k); acc[m] += (s4.x * w0 + s4.y * w1) + (s4.z * w2 + s4.w * w3); }
        }
#pragma unroll
        for (int m = 0; m < 17; ++m) red[(wave * 17 + m) * 64 + lane] = acc[m];
        __syncthreads();
        for (int idx = tid; idx < 17 * 64; idx += 512) { const int m = idx >> 6, l = idx & 63; float s = 0.f;
#pragma unroll
            for (int w = 0; w < 8; ++w) s += red[(w * 17 + m) * 64 + l];
            mods[(size_t)m * NMOD + it * 64 + l] = s + bada[it * 64 + l]; }
    }
    __syncthreads();
}
__device__ __forceinline__ int map_in(int n) {
    if (n < 1024) return 4352 + n;
    if (n < 3072) return n - 1024;
    if (n < 3104) return 3584 + (n - 3072);
    if (n < 3616) return 3840 + (n - 3104);
    if (n < 4128) return 2048 + (n - 3616);
    if (n < 5152) return 2560 + (n - 4128);
    if (n < 5168) return 3616 + (n - 5152);
    return 5376 + (n - 5168);
}
__device__ __forceinline__ int map_up(int n) {
    if (n < 2816) return n < 1280 ? n : 2560 + (n - 1280);
    const int c = n - 2816; return c < 1280 ? 1280 + c : 2560 + 1536 + (c - 1280);
}
__device__ __forceinline__ void p0_transpose_item(const float* W, int K, int N, bf16_t* WT, int mapid, LAS float* scr, int item, int lane) {
    const int nblk = (N + 31) / 32, kb = item / nblk, nb = item % nblk, k0 = 64 * kb, n0 = 32 * nb;
    const bool nok = (n0 + (lane & 31)) < N;
#pragma unroll 8
    for (int i = 0; i < 32; ++i) { const int kk = 2 * i + (lane >> 5); scr[kk * 33 + (lane & 31)] = nok ? W[(size_t)(k0 + kk) * N + n0 + (lane & 31)] : 0.f; }
    asm volatile("s_waitcnt lgkmcnt(0)" ::: "memory");
    const int c = lane & 7;
#pragma unroll
    for (int j = 0; j < 4; ++j) {
        const int n = (lane >> 3) + 8 * j; const LAS float* s = scr + (8 * c) * 33 + n;
        u32x4 o; o.x = cvt_pk_bf16(s[0 * 33], s[1 * 33]); o.y = cvt_pk_bf16(s[2 * 33], s[3 * 33]); o.z = cvt_pk_bf16(s[4 * 33], s[5 * 33]); o.w = cvt_pk_bf16(s[6 * 33], s[7 * 33]);
        const int ng = n0 + n;
        if (ng < N) {
            int row;
            if (mapid == 0) row = map_in(ng); else if (mapid == 1) row = 6400 + ng; else if (mapid == 2) row = map_up(ng); else row = ng;
            *(u32x4*)(WT + (size_t)row * K + k0 + 8 * c) = o;
        }
    }
    asm volatile("s_waitcnt lgkmcnt(0)" ::: "memory");
}
__device__ __forceinline__ void p0_weights(const Params& P, LAS uchar* lds, int lane, int wave) {
    LAS float* scr = (LAS float*)(lds + wave * 8448);
    const int gw = blockIdx.x * 8 + wave, NGW = gridDim.x * 8;
    constexpr int I_IN = 16 * 194, I_MG = 16 * 64, I_SQ = 16 * 32, I_UP = 16 * 176, I_DN = 44 * 32;
    constexpr int NITEMS = I_IN + I_MG + 3 * I_SQ + I_UP + I_DN;
    uchar* ws = P.ws;
    for (int it = gw; it < NITEMS; it += NGW) {
        int r = it;
        if (r < I_IN) { p0_transpose_item(P.in[I_WIN], 1024, 6192, (bf16_t*)(ws + WS_WG1T), 0, scr, r, lane); continue; } r -= I_IN;
        if (r < I_MG) { p0_transpose_item(P.in[I_WMERGE], 1024, 2048, (bf16_t*)(ws + WS_WG1T), 1, scr, r, lane); continue; } r -= I_MG;
        if (r < I_SQ) { p0_transpose_item(P.in[I_WBS], 1024, 1024, (bf16_t*)(ws + WS_WBS), 3, scr, r, lane); continue; } r -= I_SQ;
        if (r < I_SQ) { p0_transpose_item(P.in[I_WBG], 1024, 1024, (bf16_t*)(ws + WS_WBG), 3, scr, r, lane); continue; } r -= I_SQ;
        if (r < I_SQ) { p0_transpose_item(P.in[I_WO], 1024, 1024, (bf16_t*)(ws + WS_WO), 3, scr, r, lane); continue; } r -= I_SQ;
        if (r < I_UP) { p0_transpose_item(P.in[I_WUP], 1024, 5632, (bf16_t*)(ws + WS_WUP), 2, scr, r, lane); continue; } r -= I_UP;
        p0_transpose_item(P.in[I_WDN], 2816, 1024, (bf16_t*)(ws + WS_WDN), 3, scr, r, lane);
    }
    u32x4* pad = (u32x4*)(ws + WS_WG1T + (size_t)3632 * 2048);
    for (int i = gw * 64 + lane; i < 208 * 128; i += NGW * 64) pad[i] = (u32x4){0u, 0u, 0u, 0u};
}

__device__ __forceinline__ void norm_mod_row(const float* src, const float* g, const float* shift, const float* scale, bf16_t* dst, int lane) {
    const f32x4* xr = (const f32x4*)src + lane;
    f32x4 v[4]; float s = 0.f;
#pragma unroll
    for (int j = 0; j < 4; ++j) { v[j] = xr[64 * j]; s += (v[j].x * v[j].x + v[j].y * v[j].y) + (v[j].z * v[j].z + v[j].w * v[j].w); }
    const float rstd = rsqrtf(wave_sum(s) * (1.f / D) + EPS);
    u32x2* o8 = (u32x2*)dst + lane;
#pragma unroll
    for (int j = 0; j < 4; ++j) {
        const f32x4 gg = ((const f32x4*)g)[lane + 64 * j], sh = ((const f32x4*)shift)[lane + 64 * j], sc = ((const f32x4*)scale)[lane + 64 * j];
        const f32x4 y = (v[j] * rstd) * gg * (sc + 1.0f) + sh;
        u32x2 w; w.x = cvt_pk_bf16(y.x, y.y); w.y = cvt_pk_bf16(y.z, y.w); o8[64 * j] = w;
    }
}
__device__ __forceinline__ void phase_h(const Params& P, bf16_t* H, int nrows, int lane, int wave) {
    const float* mods = (const float*)(P.ws + WS_MODS);
    const int gw = blockIdx.x * 8 + wave, NGW = gridDim.x * 8;
    for (int m = gw; m < nrows; m += NGW) {
        const float* src; int mb;
        if (m < MX) { src = P.in[I_X] + (size_t)m * D; mb = m >> 11; } else { src = P.in[I_CTX] + (size_t)(m - MX) * D; mb = 16; }
        norm_mod_row(src, P.in[I_N1G], mods + (size_t)mb * NMOD, mods + (size_t)mb * NMOD + D, H + (size_t)m * D, lane);
    }
}
__device__ __forceinline__ void phase_norm2(const Params& P, int lane, int wave) {
    const float* mods = (const float*)(P.ws + WS_MODS);
    const int gw = blockIdx.x * 8 + wave, NGW = gridDim.x * 8;
    bf16_t* H2 = (bf16_t*)(P.ws + WS_H2);
    for (int m = gw; m < MX; m += NGW) { const int mb = m >> 11;
        norm_mod_row(P.out + (size_t)m * D, P.in[I_N2G], mods + (size_t)mb * NMOD + 3 * D, mods + (size_t)mb * NMOD + 4 * D, H2 + (size_t)m * D, lane); }
}
__device__ __forceinline__ void phase_final(const Params& P, int lane, int wave) {
    const int gw = blockIdx.x * 8 + wave, NGW = gridDim.x * 8;
    const f32x4* g4 = (const f32x4*)P.in[I_FNG];
    for (int m = gw; m < MX; m += NGW) {
        f32x4* xr = (f32x4*)(P.out + (size_t)m * D) + lane;
        f32x4 v[4]; float s = 0.f;
#pragma unroll
        for (int j = 0; j < 4; ++j) { v[j] = xr[64 * j]; s += (v[j].x * v[j].x + v[j].y * v[j].y) + (v[j].z * v[j].z + v[j].w * v[j].w); }
        const float rstd = rsqrtf(wave_sum(s) * (1.f / D) + EPS);
#pragma unroll
        for (int j = 0; j < 4; ++j) xr[64 * j] = (v[j] * rstd) * g4[lane + 64 * j];
    }
}
__device__ __forceinline__ void unpack8(const u32x4 w, float (&f)[8]) { f[0] = bf_lo(w.x); f[1] = bf_hi(w.x); f[2] = bf_lo(w.y); f[3] = bf_hi(w.y); f[4] = bf_lo(w.z); f[5] = bf_hi(w.z); f[6] = bf_lo(w.w); f[7] = bf_hi(w.w); }
__device__ __forceinline__ u32x4 pack8f(const float (&f)[8]) { u32x4 w; w.x = cvt_pk_bf16(f[0], f[1]); w.y = cvt_pk_bf16(f[2], f[3]); w.z = cvt_pk_bf16(f[4], f[5]); w.w = cvt_pk_bf16(f[6], f[7]); return w; }
__device__ __forceinline__ void phase_combine(const Params& P, int lane, int wave) {
    const int gw = blockIdx.x * 8 + wave, NGW = gridDim.x * 8;
    bf16_t* YY = (bf16_t*)(P.ws + WS_YY); bf16_t* OO = (bf16_t*)P.out;
    const bf16_t* Z = (const bf16_t*)(P.ws + WS_Z); const bf16_t* R = (const bf16_t*)(P.ws + WS_R);
    const float* sng = P.in[I_SSDNG]; const float* gng = P.in[I_GLANG];
    for (int m = gw; m < MX; m += NGW) {
        {
            bf16_t* yr = YY + (size_t)m * 2048; const bf16_t* zr = Z + (size_t)m * 1024;
            float t[2][8]; float s = 0.f;
#pragma unroll
            for (int j = 0; j < 2; ++j) {
                const int c = 8 * lane + 512 * j;
                float a[8], b[8], z[8];
                unpack8(*(const u32x4*)(yr + c), a); unpack8(*(const u32x4*)(yr + 1024 + c), b); unpack8(*(const u32x4*)(zr + c), z);
#pragma unroll
                for (int e = 0; e < 8; ++e) { t[j][e] = (a[e] + b[e]) * z[e]; s += t[j][e] * t[j][e]; }
            }
            const float rstd = rsqrtf(wave_sum(s) * (1.f / 1024.f) + EPS);
#pragma unroll
            for (int j = 0; j < 2; ++j) {
                const int c = 8 * lane + 512 * j;
                const f32x4 g0 = *(const f32x4*)(sng + c), g1 = *(const f32x4*)(sng + c + 4);
                float o[8];
#pragma unroll
                for (int e = 0; e < 4; ++e) { o[e] = t[j][e] * rstd * g0[e]; o[4 + e] = t[j][4 + e] * rstd * g1[e]; }
                *(u32x4*)(yr + c) = pack8f(o);
            }
        }
        {
            bf16_t* orow = OO + (size_t)m * 2048; const bf16_t* rr = R + (size_t)m * 1024;
            float t[2][8]; float ss[2];
#pragma unroll
            for (int j = 0; j < 2; ++j) {
                const int c = 8 * lane + 512 * j;
                float a[8], b[8];
                unpack8(*(const u32x4*)(orow + c), a); unpack8(*(const u32x4*)(orow + 1024 + c), b);
                float s = 0.f;
#pragma unroll
                for (int e = 0; e < 8; ++e) { t[j][e] = a[e] + b[e]; s += t[j][e] * t[j][e]; }
#pragma unroll
                for (int o = 1; o < 32; o <<= 1) s += __shfl_xor(s, o);
                ss[j] = rsqrtf(s * (1.f / 256.f) + EPS);
            }
#pragma unroll
            for (int j = 0; j < 2; ++j) {
                const int c = 8 * lane + 512 * j; const int ch = c & 255;
                const f32x4 g0 = *(const f32x4*)(gng + ch), g1 = *(const f32x4*)(gng + ch + 4);
                float r[8]; unpack8(*(const u32x4*)(rr + c), r);
                float o[8];
#pragma unroll
                for (int e = 0; e < 4; ++e) { o[e] = t[j][e] * ss[j] * g0[e] * r[e]; o[4 + e] = t[j][4 + e] * ss[j] * g1[e] * r[4 + e]; }
                *(u32x4*)(orow + c) = pack8f(o);
            }
        }
    }
}
__device__ __forceinline__ void phase_ffnconv(const Params& P, const bf16_t* U, int C, int coff, int tid) {
    const float* cw = P.in[I_FCW]; const float* cb = P.in[I_FCB];
    bf16_t* ACT = (bf16_t*)(P.ws + WS_ACT);
    const int CP = C >> 1;
    const long nitems = (long)NB * 32 * 4 * CP;
    const int ld = 2 * C;
    for (long it = (long)blockIdx.x * 512 + tid; it < nitems; it += (long)gridDim.x * 512) {
        const int cp = (int)(it % CP); long r = it / CP; const int jr = (int)(r & 3); r >>= 2; const int i = (int)(r & 31); const int b = (int)(r >> 5);
        const int c = 2 * cp, cg = coff + c, cv = 2816 + coff + c;
        float wg[9][2], wv[9][2];
#pragma unroll
        for (int k = 0; k < 9; ++k) { wg[k][0] = cw[k * 5632 + cg]; wg[k][1] = cw[k * 5632 + cg + 1]; wv[k][0] = cw[k * 5632 + cv]; wv[k][1] = cw[k * 5632 + cv + 1]; }
        const float bg0 = cb[cg], bg1 = cb[cg + 1], bv0 = cb[cv], bv1 = cb[cv + 1];
        const bf16_t* Ub = U + (size_t)b * 2048 * ld;
        unsigned gwin[3][3], vwin[3][3];
        const int j0 = jr * 16;
#pragma unroll
        for (int a = 0; a < 3; ++a) {
            const int ii = i + a - 1; const bool rok = (ii >= 0 && ii < 32);
#pragma unroll
            for (int q = 0; q < 2; ++q) {
                const int jj = j0 - 1 + q; const bool ok = rok && jj >= 0;
                const size_t off = (size_t)(ii * 64 + jj) * ld;
                gwin[a][q + 1] = ok ? *(const unsigned*)(Ub + off + c) : 0u;
                vwin[a][q + 1] = ok ? *(const unsigned*)(Ub + off + C + c) : 0u;
            }
        }
        for (int j = j0; j < j0 + 16; ++j) {
#pragma unroll
            for (int a = 0; a < 3; ++a) {
                gwin[a][0] = gwin[a][1]; gwin[a][1] = gwin[a][2]; vwin[a][0] = vwin[a][1]; vwin[a][1] = vwin[a][2];
                const int ii = i + a - 1; const bool ok = (ii >= 0 && ii < 32) && (j + 1 < 64);
                const size_t off = (size_t)(ii * 64 + j + 1) * ld;
                gwin[a][2] = ok ? *(const unsigned*)(Ub + off + c) : 0u;
                vwin[a][2] = ok ? *(const unsigned*)(Ub + off + C + c) : 0u;
            }
            float g0 = bg0, g1 = bg1, v0 = bv0, v1 = bv1;
#pragma unroll
            for (int a = 0; a < 3; ++a)
#pragma unroll
                for (int q = 0; q < 3; ++q) {
                    g0 += wg[a * 3 + q][0] * bf_lo(gwin[a][q]); g1 += wg[a * 3 + q][1] * bf_hi(gwin[a][q]);
                    v0 += wv[a * 3 + q][0] * bf_lo(vwin[a][q]); v1 += wv[a * 3 + q][1] * bf_hi(vwin[a][q]);
                }
            const size_t tok = (size_t)b * 2048 + i * 64 + j;
            *(unsigned*)(ACT + tok * DFF + cg) = cvt_pk_bf16(silu_f(g0) * v0, silu_f(g1) * v1);
        }
    }
}

constexpr int SL_A1 = 0;
constexpr int SL_A2 = 17408;
constexpr int SL_A3 = 34816;
constexpr int SL_A4 = 68608;
constexpr int SL_A5 = 105472;
constexpr int SL_A6 = 138240;
constexpr int SL_A7 = 146432;
constexpr int LD128 = 272, LD256 = 528, LD64 = 144;

__device__ __forceinline__ int launder(int x) { asm volatile("" : "+v"(x)); return x; }
__device__ __forceinline__ int crow(int i, int h) { return (i & 3) + 8 * (i >> 2) + 4 * h; }
__device__ __forceinline__ bf16x8 frag_row(const LAS uchar* base, int ld, int row, int k0, int h) { return *(const LAS bf16x8*)(base + row * ld + (k0 + 8 * h) * 2); }
__device__ __forceinline__ bf16x8 frag_row_sigma(const LAS uchar* base, int ld, int row, int k0, int h) {
    const s16x4 a = *(const LAS s16x4*)(base + row * ld + (k0 + 4 * h) * 2);
    const s16x4 b = *(const LAS s16x4*)(base + row * ld + (k0 + 8 + 4 * h) * 2);
    return __builtin_shufflevector(a, b, 0, 1, 2, 3, 4, 5, 6, 7);
}
__device__ __forceinline__ s16x4 tr16(const LAS uchar* p) { return __builtin_bit_cast(s16x4, __builtin_amdgcn_ds_read_tr16_b64_v4i16((LAS s16x4*)p)); }
__device__ __forceinline__ bf16x8 frag_tr(const LAS uchar* base, int ld, int k0, int c0, int lane) {
    const int h = lane >> 5, blk = (lane >> 4) & 1, q = (lane & 15) >> 2, p = lane & 3;
    const LAS uchar* a0 = base + (k0 + 8 * h + q) * ld + (c0 + 16 * blk + 4 * p) * 2;
    const s16x4 lo = tr16(a0), hi = tr16(a0 + 4 * ld);
    return __builtin_shufflevector(lo, hi, 0, 1, 2, 3, 4, 5, 6, 7);
}
#define MFMA32(a, b, c) __builtin_amdgcn_mfma_f32_32x32x16_bf16((a), (b), (c), 0, 0, 0)
template <int S> __device__ __forceinline__ bf16x8 pack_step(const f32x16& x) {
    u32x4 p; p.x = cvt_pk_bf16(x[8 * S], x[8 * S + 1]); p.y = cvt_pk_bf16(x[8 * S + 2], x[8 * S + 3]); p.z = cvt_pk_bf16(x[8 * S + 4], x[8 * S + 5]); p.w = cvt_pk_bf16(x[8 * S + 6], x[8 * S + 7]);
    return __builtin_bit_cast(bf16x8, p);
}

template <bool SSD>
__device__ __forceinline__ void scan_engine(f32x16 (&accS)[4], const LAS uchar* Aq, const LAS uchar* Mm, const LAS uchar* Val, int c0, const LAS uchar* Kt,
                                            const LAS float* rs, const LAS float* wv, float dec_s, const LAS float* decv,
                                            bool with_out, bf16_t* outp, int dir, int lane) {
    const int r = lane & 31, h = lane >> 5;
#define SBAR0() __builtin_amdgcn_sched_barrier(0)
    if (with_out) {
        f32x16 o[2];
#pragma unroll
        for (int i = 0; i < 16; ++i) { o[0][i] = 0.f; o[1][i] = 0.f; }
#pragma unroll
        for (int nt = 0; nt < 4; ++nt) {
            const bf16x8 b0 = pack_step<0>(accS[nt]), b1 = pack_step<1>(accS[nt]);
#pragma unroll
            for (int mt = 0; mt < 2; ++mt) {
                o[mt] = MFMA32(frag_row_sigma(Aq, LD128, 32 * mt + r, 32 * nt, h), b0, o[mt]);
                o[mt] = MFMA32(frag_row_sigma(Aq, LD128, 32 * mt + r, 32 * nt + 16, h), b1, o[mt]);
            }
            SBAR0();
        }
        if (SSD) {
#pragma unroll
            for (int mt = 0; mt < 2; ++mt)
#pragma unroll
                for (int g4 = 0; g4 < 4; ++g4) {
                    const f32x4 sc = *(const LAS f32x4*)(rs + 32 * mt + 8 * g4 + 4 * h);
#pragma unroll
                    for (int e = 0; e < 4; ++e) o[mt][4 * g4 + e] *= sc[e];
                }
            SBAR0();
        }
#pragma unroll
        for (int ks = 0; ks < 4; ++ks) {
            const bf16x8 vb = frag_tr(Val, LD256, 16 * ks, c0, lane);
            if (ks < 2) o[0] = MFMA32(frag_row(Mm, LD64, r, 16 * ks, h), vb, o[0]);
            o[1] = MFMA32(frag_row(Mm, LD64, 32 + r, 16 * ks, h), vb, o[1]);
            SBAR0();
        }
#pragma unroll
        for (int mt = 0; mt < 2; ++mt)
#pragma unroll
            for (int i = 0; i < 16; ++i) {
                const int q = 32 * mt + crow(i, h); const int tok = dir ? 63 - q : q;
                outp[(size_t)tok * 2048] = (bf16_t)(cvt_pk_bf16(o[mt][i], 0.f) & 0xffffu);
            }
        SBAR0();
    }
#pragma unroll
    for (int nt = 0; nt < 4; ++nt) {
#pragma unroll
        for (int g4 = 0; g4 < 4; ++g4) {
            f32x4 dv;
            if (SSD) dv = (f32x4){dec_s, dec_s, dec_s, dec_s}; else dv = *(const LAS f32x4*)(decv + 32 * nt + 8 * g4 + 4 * h);
#pragma unroll
            for (int e = 0; e < 4; ++e) accS[nt][4 * g4 + e] *= dv[e];
        }
    }
    SBAR0();
#pragma unroll
    for (int ks = 0; ks < 4; ++ks) {
        bf16x8 b = frag_tr(Val, LD256, 16 * ks, c0, lane);
        if (SSD) {
            const f32x4 w0 = *(const LAS f32x4*)(wv + 16 * ks + 8 * h), w1 = *(const LAS f32x4*)(wv + 16 * ks + 8 * h + 4);
            const u32x4 bu = __builtin_bit_cast(u32x4, b);
            u32x4 o;
            o.x = cvt_pk_bf16(bf_lo(bu.x) * w0.x, bf_hi(bu.x) * w0.y); o.y = cvt_pk_bf16(bf_lo(bu.y) * w0.z, bf_hi(bu.y) * w0.w);
            o.z = cvt_pk_bf16(bf_lo(bu.z) * w1.x, bf_hi(bu.z) * w1.y); o.w = cvt_pk_bf16(bf_lo(bu.w) * w1.z, bf_hi(bu.w) * w1.w);
            b = __builtin_bit_cast(bf16x8, o);
        }
#pragma unroll
        for (int nt = 0; nt < 4; ++nt) accS[nt] = MFMA32(frag_tr(Kt, LD128, 16 * ks, 32 * nt, lane), b, accS[nt]);
        SBAR0();
    }
#undef SBAR0
}

__device__ __forceinline__ void scan_ssd(const Params& P, LAS uchar* lds, int item, int tid0, int lane0, int wave) {
    const int b = item >> 3, dir = (item >> 2) & 1, g = item & 3;
    LAS uchar* Cm = lds + SL_A1; LAS uchar* Bm = lds + SL_A2; LAS uchar* XS = lds + SL_A3; LAS uchar* MmB = lds + SL_A4;
    LAS float* CBf = (LAS float*)(lds + SL_A5);
    LAS float* dts = (LAS float*)(lds + SL_A6);
    LAS float* cumv = dts + 256; LAS float* rsv = dts + 512; LAS float* wvv = dts + 768; LAS float* decs = dts + 1024;
    LAS float* CW = (LAS float*)(lds + SL_A7);
    const bf16_t* XBC = (const bf16_t*)(P.ws + WS_XBC); const float* DT = (const float*)(P.ws + WS_DT);
    bf16_t* YY = (bf16_t*)(P.ws + WS_YY);
    const float* convw = P.in[I_SCW]; const float* convb = P.in[I_SCB];
    __syncthreads();
    { const int tid = tid0;
    for (int idx = tid; idx < 2048; idx += 512) {
        const int j = idx >> 9, c = idx & 511;
        const int col = c < 256 ? g * 256 + c : (c < 384 ? 1024 + g * 128 + (c - 256) : 1536 + g * 128 + (c - 384));
        CW[idx] = j < 3 ? convw[j * 2048 + col] : convb[col];
    } }
    f32x16 accS[4];
#pragma unroll
    for (int nt = 0; nt < 4; ++nt)
#pragma unroll
        for (int i = 0; i < 16; ++i) accS[nt][i] = 0.f;
    for (int st = 0; st < 36; ++st) {
        const bool with_out = st >= 4;
        const int tid = launder(tid0); const int lane = tid & 63;
        const int strip = tid & 63, rg = tid >> 6;
        const int xcol = strip < 32 ? g * 256 + 8 * strip : (strip < 48 ? 1024 + g * 128 + 8 * (strip - 32) : 1536 + g * 128 + 8 * (strip - 48));
        long base, seq_lo, seq_hi;
        if (st < 4) { const int cc = dir ? 3 - st : st; seq_lo = (long)MX + b * 256; seq_hi = seq_lo + 256; base = seq_lo + cc * 64; }
        else { const int lc = dir ? 35 - st : st - 4; seq_lo = (long)b * 2048; seq_hi = seq_lo + 2048; base = seq_lo + lc * 64; }
        __syncthreads();
        {
            u32x4 v[10];
#pragma unroll
            for (int i = 0; i < 10; ++i) {
                const long grow = base + 8 * rg - 1 + i;
                v[i] = (grow >= seq_lo && grow < seq_hi) ? *(const u32x4*)(XBC + (size_t)grow * 2048 + xcol) : (u32x4){0u, 0u, 0u, 0u};
            }
            float w0[8], w1[8], w2[8], bb[8];
#pragma unroll
            for (int e = 0; e < 8; ++e) { w0[e] = CW[8 * strip + e]; w1[e] = CW[512 + 8 * strip + e]; w2[e] = CW[1024 + 8 * strip + e]; bb[e] = CW[1536 + 8 * strip + e]; }
            LAS uchar* dstb; int dld, dc;
            if (strip < 32) { dstb = XS; dld = LD256; dc = 8 * strip; } else if (strip < 48) { dstb = Bm; dld = LD128; dc = 8 * (strip - 32); } else { dstb = Cm; dld = LD128; dc = 8 * (strip - 48); }
#pragma unroll
            for (int j = 0; j < 8; ++j) {
                float x0[8], x1[8], x2[8], o[8];
                unpack8(v[j], x0); unpack8(v[j + 1], x1); unpack8(v[j + 2], x2);
#pragma unroll
                for (int e = 0; e < 8; ++e) o[e] = silu_f(w0[e] * x0[e] + w1[e] * x1[e] + w2[e] * x2[e] + bb[e]);
                const int tt = 8 * rg + j; const int s = dir ? 63 - tt : tt;
                *(LAS u32x4*)(dstb + s * dld + dc * 2) = pack8f(o);
            }
            if (tid < 256) { const int s = tid >> 2, hl = tid & 3; const int tt = dir ? 63 - s : s;
                dts[hl * 64 + s] = DT[(size_t)(base + tt) * 32 + dir * 16 + 4 * g + hl]; }
        }
        __syncthreads();
        if (wave < 4) {
            const int hl = wave;
            const float a = -__expf(P.in[I_ALOG][dir * 16 + 4 * g + hl]);
            const float dt = dts[hl * 64 + lane];
            float c = dt * a;
#pragma unroll
            for (int off = 1; off < 64; off <<= 1) { const float t = __shfl_up(c, off); if (lane >= off) c += t; }
            const float last = __shfl(c, 63);
            cumv[hl * 64 + lane] = c; rsv[hl * 64 + lane] = __expf(c); wvv[hl * 64 + lane] = dt * __expf(last - c);
            if (lane == 0) decs[hl] = __expf(last);
        } else if (wave < 7 && with_out) {
            const int ti = wave - 4; const int mt = ti > 0 ? 1 : 0, st_ = ti == 2 ? 1 : 0;
            const int r = lane & 31, h = lane >> 5;
            f32x16 cb;
#pragma unroll
            for (int i = 0; i < 16; ++i) cb[i] = 0.f;
#pragma unroll
            for (int ks = 0; ks < 8; ++ks) cb = MFMA32(frag_row(Cm, LD128, 32 * mt + r, 16 * ks, h), frag_row(Bm, LD128, 32 * st_ + r, 16 * ks, h), cb);
#pragma unroll
            for (int i = 0; i < 16; ++i) CBf[(32 * mt + crow(i, h)) * 64 + 32 * st_ + r] = cb[i];
        }
        __syncthreads();
        if (with_out) {
            float dsk[4];
#pragma unroll
            for (int hl = 0; hl < 4; ++hl) dsk[hl] = dir == 0 ? P.in[I_SSDD][4 * g + hl] : 0.f;
#pragma unroll
            for (int it = 0; it < 4; ++it) {
                const int pidx = tid + 512 * it; const int q = pidx >> 5, s = 2 * (pidx & 31);
                const float cb0 = CBf[q * 64 + s], cb1 = CBf[q * 64 + s + 1];
#pragma unroll
                for (int hl = 0; hl < 4; ++hl) {
                    const float cq = cumv[hl * 64 + q];
                    float v0 = (s <= q) ? cb0 * __expf(cq - cumv[hl * 64 + s]) * dts[hl * 64 + s] : 0.f;
                    float v1 = (s + 1 <= q) ? cb1 * __expf(cq - cumv[hl * 64 + s + 1]) * dts[hl * 64 + s + 1] : 0.f;
                    if (s == q) v0 += dsk[hl];
                    if (s + 1 == q) v1 += dsk[hl];
                    *(LAS unsigned*)(MmB + hl * 9216 + q * LD64 + s * 2) = cvt_pk_bf16(v0, v1);
                }
            }
        }
        __syncthreads();
        {
            const int hl = wave >> 1, c0 = 64 * hl + 32 * (wave & 1);
            bf16_t* outp = YY + (size_t)base * 2048 + dir * 1024 + (4 * g + hl) * 64 + 32 * (wave & 1) + (lane & 31);
            scan_engine<true>(accS, Cm, MmB + hl * 9216, XS, c0, Bm, rsv + hl * 64, wvv + hl * 64, decs[hl], nullptr, with_out, outp, dir, lane);
        }
    }
}

__device__ __forceinline__ void scan_gla(const Params& P, LAS uchar* lds, int item, int tid0, int lane0, int wave) {
    const int b = item >> 3, dir = (item >> 2) & 1, hh = item & 3;
    LAS uchar* QA = lds + SL_A1; LAS uchar* KA = lds + SL_A2; LAS uchar* VV = lds + SL_A3; LAS uchar* QT = lds + SL_A4; LAS uchar* KH = lds + SL_A4 + 17408;
    LAS float* CUM = (LAS float*)(lds + SL_A5); LAS uchar* Mm = lds + SL_A5;
    LAS float* segtot = (LAS float*)(lds + SL_A6);
    LAS float* offv = segtot + 512;
    LAS float* refv = segtot + 1024; LAS float* eref = segtot + 1152; LAS float* elr = segtot + 1280; LAS float* decv = segtot + 1408; LAS float* gb = segtot + 1536;
    LAS uchar* GLRs = lds + SL_A7; LAS uchar* GWT = lds + SL_A7 + 3072;
    const bf16_t* Qg = (const bf16_t*)(P.ws + WS_Q); const bf16_t* Kg = (const bf16_t*)(P.ws + WS_K); const bf16_t* Vg = (const bf16_t*)(P.ws + WS_V);
    const bf16_t* GLR = (const bf16_t*)(P.ws + WS_GLR);
    bf16_t* OO = (bf16_t*)P.out;
    __syncthreads();
    { const int tid = tid0;
    for (int idx = tid; idx < 2048; idx += 512) {
        const int kc = idx & 127, r16 = idx >> 7;
        const float w = P.in[I_GGW][dir * 8192 + r16 * 512 + hh * 128 + kc];
        *(LAS bf16_t*)(GWT + kc * 48 + r16 * 2) = (bf16_t)(cvt_pk_bf16(w, 0.f) & 0xffffu);
    }
    if (tid < 128) gb[tid] = P.in[I_GGB][dir * 512 + hh * 128 + tid]; }
    f32x16 accS[4];
#pragma unroll
    for (int nt = 0; nt < 4; ++nt)
#pragma unroll
        for (int i = 0; i < 16; ++i) accS[nt][i] = 0.f;
    for (int st = 0; st < 36; ++st) {
        const bool with_out = st >= 4;
        const int tid = launder(tid0); const int lane = tid & 63;
        const int r = lane & 31, h = lane >> 5;
        long base;
        if (st < 4) { const int cc = dir ? 3 - st : st; base = (long)MX + b * 256 + cc * 64; }
        else { const int lc = dir ? 35 - st : st - 4; base = (long)b * 2048 + lc * 64; }
        __syncthreads();
#pragma unroll
        for (int i = 0; i < 2; ++i) {
            const int idx = tid + 512 * i; const int tt = idx >> 4, ch = idx & 15; const int s = dir ? 63 - tt : tt;
            *(LAS u32x4*)(KA + s * LD128 + ch * 16) = *(const u32x4*)(Kg + (size_t)(base + tt) * 512 + hh * 128 + ch * 8);
            if (with_out) *(LAS u32x4*)(QA + s * LD128 + ch * 16) = *(const u32x4*)(Qg + (size_t)(base + tt) * 512 + hh * 128 + ch * 8);
        }
#pragma unroll
        for (int i = 0; i < 4; ++i) {
            const int idx = tid + 512 * i; const int tt = idx >> 5, ch = idx & 31; const int s = dir ? 63 - tt : tt;
            *(LAS u32x4*)(VV + s * LD256 + ch * 16) = *(const u32x4*)(Vg + (size_t)(base + tt) * 1024 + hh * 256 + ch * 8);
        }
        if (tid < 128) { const int tt = tid >> 1, hf = tid & 1; const int s = dir ? 63 - tt : tt;
            *(LAS u32x4*)(GLRs + s * 48 + hf * 16) = *(const u32x4*)(GLR + (size_t)(base + tt) * 16 + hf * 8); }
        __syncthreads();
        {
            const int st_ = wave >> 2, kt = wave & 3;
            f32x16 z;
#pragma unroll
            for (int i = 0; i < 16; ++i) z[i] = 0.f;
            const bf16x8 a = *(const LAS bf16x8*)(GLRs + (32 * st_ + r) * 48 + 16 * h);
            const bf16x8 bw = *(const LAS bf16x8*)(GWT + (32 * kt + r) * 48 + 16 * h);
            z = MFMA32(a, bw, z);
            const float gbk = gb[32 * kt + r];
#pragma unroll
            for (int i = 0; i < 16; ++i) {
                const float x = z[i] + gbk;
                const float la = -(fmaxf(-x, 0.f) + __logf(1.0f + __expf(-fabsf(x)))) * 0.0625f;
                CUM[(32 * st_ + crow(i, h)) * 128 + 32 * kt + r] = la;
            }
        }
        __syncthreads();
        {
            const int kc = tid & 127, seg = tid >> 7; float run = 0.f;
#pragma unroll
            for (int i = 0; i < 16; ++i) { const int s = 16 * seg + i; run += CUM[s * 128 + kc]; CUM[s * 128 + kc] = run; }
            segtot[seg * 128 + kc] = run;
        }
        __syncthreads();
        if (tid < 128) {
            const float t0 = segtot[tid], t1 = segtot[128 + tid], t2 = segtot[256 + tid], t3 = segtot[384 + tid];
            offv[tid] = 0.f; offv[128 + tid] = t0; offv[256 + tid] = t0 + t1; offv[384 + tid] = t0 + t1 + t2;
            const float last = t0 + t1 + t2 + t3, ref = CUM[31 * 128 + tid] + t0;
            refv[tid] = ref; eref[tid] = __expf(ref); elr[tid] = __expf(last - ref); decv[tid] = __expf(last);
        }
        __syncthreads();
#pragma unroll
        for (int i = 0; i < 2; ++i) {
            const int idx = tid + 512 * i; const int s = idx >> 4, ch = idx & 15, k0 = 8 * ch, seg = s >> 4;
            float eq[8], ek[8];
#pragma unroll
            for (int e = 0; e < 8; ++e) { const float d = CUM[s * 128 + k0 + e] + offv[seg * 128 + k0 + e] - refv[k0 + e]; eq[e] = __expf(d); ek[e] = __expf(-d); }
            float kr[8], o1[8], o2[8];
            unpack8(*(const LAS u32x4*)(KA + s * LD128 + ch * 16), kr);
#pragma unroll
            for (int e = 0; e < 8; ++e) { o1[e] = kr[e] * ek[e]; o2[e] = o1[e] * elr[k0 + e]; }
            *(LAS u32x4*)(KA + s * LD128 + ch * 16) = pack8f(o1);
            *(LAS u32x4*)(KH + s * LD128 + ch * 16) = pack8f(o2);
            if (with_out) {
                float qr[8];
                unpack8(*(const LAS u32x4*)(QA + s * LD128 + ch * 16), qr);
#pragma unroll
                for (int e = 0; e < 8; ++e) { o1[e] = qr[e] * eq[e]; o2[e] = o1[e] * eref[k0 + e]; }
                *(LAS u32x4*)(QT + s * LD128 + ch * 16) = pack8f(o1);
                *(LAS u32x4*)(QA + s * LD128 + ch * 16) = pack8f(o2);
            }
        }
        __syncthreads();
        if (with_out && wave < 3) {
            const int mt = wave > 0 ? 1 : 0, st_ = wave == 2 ? 1 : 0;
            f32x16 sc;
#pragma unroll
            for (int i = 0; i < 16; ++i) sc[i] = 0.f;
#pragma unroll
            for (int ks = 0; ks < 8; ++ks) sc = MFMA32(frag_row(QT, LD128, 32 * mt + r, 16 * ks, h), frag_row(KA, LD128, 32 * st_ + r, 16 * ks, h), sc);
#pragma unroll
            for (int i = 0; i < 16; ++i) {
                const int q = 32 * mt + crow(i, h), s = 32 * st_ + r;
                const float v = (s <= q) ? sc[i] : 0.f;
                *(LAS bf16_t*)(Mm + q * LD64 + s * 2) = (bf16_t)(cvt_pk_bf16(v, 0.f) & 0xffffu);
            }
        }
        __syncthreads();
        {
            const int c0 = 32 * wave;
            bf16_t* outp = OO + (size_t)base * 2048 + dir * 1024 + hh * 256 + c0 + r;
            scan_engine<false>(accS, QA, Mm, VV, c0, KH, nullptr, nullptr, 1.f, decv, with_out, outp, dir, lane);
        }
    }
}

__global__ void __launch_bounds__(512, 2) fwd_kernel(Params P) {
    extern __shared__ __attribute__((aligned(16))) uchar lds_raw[];
    LAS uchar* lds = (LAS uchar*)lds_raw;
    const int tid = threadIdx.x, lane = tid & 63, wave = __builtin_amdgcn_readfirstlane(tid >> 6);
    const int G = gridDim.x;
    volatile LAS unsigned* MISC = (volatile LAS unsigned*)(lds + MISC_OFF);
    if (tid < 64) MISC[tid] = 0u;
    __syncthreads();
    uchar* ws = P.ws;
    XcdBarrier bar; bar.bar = (unsigned*)(ws + WS_CTL) + CW_BAR; bar.x = 0; bar.st = nullptr;
    if (MK_N_LAUNCHES == 1) bar = xcd_barrier_post((unsigned*)(ws + WS_CTL) + CW_BAR, MISC + 8);
    const int lo = P.ph_lo, hi = P.ph_hi;
#ifndef PHMASK
#define PHMASK 0xFFFF
#endif
#define IN(k) ((((PHMASK) >> (k)) & 1) && lo <= (k) && (k) < hi)
#define SEAM(k) do { if (IN(k) && IN((k) + 1)) xcd_barrier(bar); } while (0)
    const float* mods = (const float*)(ws + WS_MODS);

    if (IN(0)) { p0_mods(P, lds, tid, lane, wave); p0_weights(P, lds, lane, wave); }
    SEAM(0);
    if (IN(1)) { phase_h(P, (bf16_t*)P.out, MALL, lane, wave); }
    SEAM(1);
    if (IN(2)) {
        pg8::Gemm g{(const bf16_t*)P.out, (const bf16_t*)(ws + WS_WG1T), 1024, 1024};
        pg8::Sched S; S.init(128, 17, G, (int)blockIdx.x, 128, 16, 15);
        EpiBf E{EK_G1, ws, P.in[I_DTB], P.in[I_BMERGE], nullptr, 0, 0};
        pg8::gemm_phase<EpiBf>(lds, g, S, E);
    }
    SEAM(2);
    if (IN(3)) {
        for (int item = blockIdx.x; item < 256; item += G) {
#ifndef SCANSEL
#define SCANSEL 3
#endif
            if (item < 128) { if (SCANSEL & 1) scan_ssd(P, lds, item, tid, lane, wave); } else { if (SCANSEL & 2) scan_gla(P, lds, item - 128, tid, lane, wave); }
        }
    }
    SEAM(3);
    if (IN(4)) { phase_h(P, (bf16_t*)(ws + WS_HX), MX, lane, wave); }
    SEAM(4);
    if (IN(5)) {
        pg8::Gemm g{(const bf16_t*)(ws + WS_HX), (const bf16_t*)(ws + WS_WG1T) + (size_t)17 * 256 * 1024, 1024, 1024};
        pg8::Sched S; S.init(128, 16, G, (int)blockIdx.x);
        EpiBf E{EK_G1, ws, P.in[I_DTB], P.in[I_BMERGE], nullptr, 0, 17};
        pg8::gemm_phase<EpiBf>(lds, g, S, E);
    }
    SEAM(5);
    if (IN(6)) { phase_combine(P, lane, wave); }
    SEAM(6);
    if (IN(7)) {
        { pg8::Gemm g{(const bf16_t*)(ws + WS_YY), (const bf16_t*)(ws + WS_WBS), 2048, 1024};
          pg8::Sched S; S.init(128, 4, G, (int)blockIdx.x);
          EpiBf E{EK_G2A, ws, nullptr, nullptr, nullptr, 0, 0};
          pg8::gemm_phase<EpiBf>(lds, g, S, E); }
        asm volatile("s_waitcnt vmcnt(0)" ::: "memory"); __syncthreads();
        { pg8::Gemm g{(const bf16_t*)P.out, (const bf16_t*)(ws + WS_WBG), 2048, 1024};
          pg8::Sched S; S.init(128, 4, G, (int)blockIdx.x);
          EpiBf E{EK_G2B, ws, nullptr, nullptr, nullptr, 0, 0};
          pg8::gemm_phase<EpiBf>(lds, g, S, E); }
    }
    SEAM(7);
    if (IN(8)) {
        pg8::Gemm g{(const bf16_t*)(ws + WS_MERGED), (const bf16_t*)(ws + WS_WO), 1024, 1024};
        pg8::Sched S; S.init(128, 4, G, (int)blockIdx.x);
        EpiRes E{P.in[I_X], P.out, mods + 2 * D};
        pg8::gemm_phase<EpiRes>(lds, g, S, E);
    }
    SEAM(8);
    if (IN(9)) { phase_norm2(P, lane, wave); }
    SEAM(9);
    if (IN(10)) {
        pg8::Gemm g{(const bf16_t*)(ws + WS_H2), (const bf16_t*)(ws + WS_WUP), 1024, 1024};
        pg8::Sched S; S.init(128, 10, G, (int)blockIdx.x);
        EpiBf E{EK_PLAIN, ws, nullptr, nullptr, (bf16_t*)(ws + WS_UA), 2560, 0};
        pg8::gemm_phase<EpiBf>(lds, g, S, E);
    }
    SEAM(10);
    if (IN(11)) { phase_ffnconv(P, (const bf16_t*)(ws + WS_UA), 1280, 0, tid); }
    SEAM(11);
    if (IN(12)) {
        pg8::Gemm g{(const bf16_t*)(ws + WS_H2), (const bf16_t*)(ws + WS_WUP) + (size_t)2560 * 1024, 1024, 1024};
        pg8::Sched S; S.init(128, 12, G, (int)blockIdx.x);
        EpiBf E{EK_PLAIN, ws, nullptr, nullptr, (bf16_t*)(ws + WS_UB), 3072, 0};
        pg8::gemm_phase<EpiBf>(lds, g, S, E);
    }
    SEAM(12);
    if (IN(13)) { phase_ffnconv(P, (const bf16_t*)(ws + WS_UB), 1536, 1280, tid); }
    SEAM(13);
    if (IN(14)) {
        pg8::Gemm g{(const bf16_t*)(ws + WS_ACT), (const bf16_t*)(ws + WS_WDN), 2816, 2816};
        pg8::Sched S; S.init(128, 4, G, (int)blockIdx.x);
        EpiRes E{P.out, P.out, mods + 5 * D};
        pg8::gemm_phase<EpiRes>(lds, g, S, E);
    }
    SEAM(14);
    if (IN(15)) { phase_final(P, lane, wave); }
#undef IN
#undef SEAM
}

extern "C" void kernel_launch(void* const* d_in, const int* in_sizes, int n_in, void* d_out, int out_size, void* d_ws, size_t ws_size, hipStream_t stream) {
    static int grid = 0;
    if (grid == 0) {
        if (n_in != 28 || out_size != MX * D || ws_size < WS_END) { fprintf(stderr, "kernel_launch: unexpected shapes n_in %d out %d ws %zu\n", n_in, out_size, ws_size); grid = -1; return; }
        int dev = 0, cus = 0;
        if (hipGetDevice(&dev) != hipSuccess || hipDeviceGetAttribute(&cus, hipDeviceAttributeMultiprocessorCount, dev) != hipSuccess) { grid = -1; return; }
        if (hipFuncSetAttribute((const void*)fwd_kernel, hipFuncAttributeMaxDynamicSharedMemorySize, LDS_BYTES) != hipSuccess) { fprintf(stderr, "kernel_launch: hipFuncSetAttribute failed\n"); grid = -1; return; }
        int per_cu = 0;
        (void)hipOccupancyMaxActiveBlocksPerMultiprocessor(&per_cu, (const void*)fwd_kernel, 512, LDS_BYTES);
        (void)hipGetLastError();
        grid = cus;
    }
    if (grid < 0) return;
    (void)hipMemsetAsync((char*)d_ws + WS_CTL, 0, CTL_ZERO_BYTES, stream);
    Params a{};
    for (int i = 0; i < 28; ++i) a.in[i] = (const float*)d_in[i];
    a.out = (float*)d_out; a.ws = (uchar*)d_ws;
    if (MK_N_LAUNCHES == 1) {
        a.ph_lo = 0; a.ph_hi = NPH;
        hipLaunchKernelGGL(fwd_kernel, dim3(grid), dim3(512), LDS_BYTES, stream, a);
    } else {
        for (int ph = 0; ph < NPH; ++ph) { a.ph_lo = ph; a.ph_hi = ph + 1; hipLaunchKernelGGL(fwd_kernel, dim3(grid), dim3(512), LDS_BYTES, stream, a); }
    }
}
```
